# Optimizing an MI355X kernel written in HIP

```python
import jax, jax.numpy as jnp
from jax import lax
import numpy as np

D_MODEL = 1024
BATCH = 2
SEQ = 8192
DEPTH = 1

EPS = 1e-6
SSD_HEAD_DIM = 64
SSD_HEADS = 16
SSD_WIDTH = SSD_HEADS * SSD_HEAD_DIM
SSD_GROUPS = 2
D_STATE = 128
D_CONV = 3
CHUNK = 128
HEAD_DIM = 64
N_HEADS = 16
N_KV_HEADS = 4
ATTN_WIDTH = N_HEADS * HEAD_DIM
KV_WIDTH = N_KV_HEADS * HEAD_DIM
ROT_DIM = HEAD_DIM // 4
ROPE_THETA = 500000.0
WINDOW = 128
BLOCK = 128
MIX_WIDTH = SSD_WIDTH + ATTN_WIDTH
PLE_DIM = 256
BC_WIDTH = SSD_GROUPS * D_STATE
XBC_WIDTH = SSD_WIDTH + 2 * BC_WIDTH
IN_SPLIT_SIZES = (SSD_WIDTH, XBC_WIDTH, 2 * SSD_HEADS, ATTN_WIDTH, KV_WIDTH, KV_WIDTH, ATTN_WIDTH)
IN_WIDTH = int(sum(IN_SPLIT_SIZES))

kernel_name = "hybrid_ssd_swa_parallel_heads_encoder"


def _rmsnorm(x, w):
    xf = x.astype(jnp.float32)
    xf = xf * lax.rsqrt(jnp.mean(xf * xf, axis=-1, keepdims=True) + EPS)
    return (xf * w.astype(jnp.float32)).astype(x.dtype)


def _ssd_chunked(x, dt, A, B, C):
    b, l, h, p = x.shape
    g, n = B.shape[2], B.shape[3]
    r = h // g
    c = l // CHUNK
    x = x.reshape(b, c, CHUNK, g, r, p)
    dt = dt.reshape(b, c, CHUNK, g, r)
    B = B.reshape(b, c, CHUNK, g, n)
    C = C.reshape(b, c, CHUNK, g, n)
    xdt = x * dt[..., None]
    a_cum = jnp.cumsum(dt * A.reshape(g, r), axis=2)
    seg = a_cum[:, :, :, None] - a_cum[:, :, None, :]
    tril = jnp.tril(jnp.ones((CHUNK, CHUNK), dtype=bool))[:, :, None, None]
    decay = jnp.exp(jnp.where(tril, seg, -jnp.inf))
    cb = jnp.einsum('bcqgn,bcsgn->bcqsg', C, B)
    y_diag = jnp.einsum('bcqsg,bcqsgr,bcsgrp->bcqgrp', cb, decay, xdt)
    decay_to_end = jnp.exp(a_cum[:, :, -1:] - a_cum)
    states = jnp.einsum('bcsgn,bcsgr,bcsgrp->bcgrpn', B, decay_to_end, xdt)
    chunk_decay = jnp.exp(a_cum[:, :, -1])

    def step(hc, inp):
        dec, st = inp
        return hc * dec[..., None, None] + st, hc

    h0 = jnp.zeros((b, g, r, p, n), jnp.float32)
    _, prev = lax.scan(step, h0, (jnp.moveaxis(chunk_decay, 1, 0), jnp.moveaxis(states, 1, 0)))
    prev = jnp.moveaxis(prev, 0, 1)
    y_off = jnp.einsum('bcqgn,bcgrpn,bcqgr->bcqgrp', C, prev, jnp.exp(a_cum))
    return (y_diag + y_off).reshape(b, l, h, p)


def _rope_partial(t, cos, sin):
    half = ROT_DIM // 2
    tf = t.astype(jnp.float32)
    t1, t2, rest = tf[..., :half], tf[..., half:ROT_DIM], tf[..., ROT_DIM:]
    c = cos[None, :, None, :]
    s = sin[None, :, None, :]
    out = jnp.concatenate([t1 * c - t2 * s, t2 * c + t1 * s, rest], axis=-1)
    return out.astype(t.dtype)


def _window_attention(q, k, v, sink):
    b, l, h, d = q.shape
    kvh = k.shape[2]
    r = h // kvh
    nb = l // BLOCK
    qb = q.reshape(b, nb, BLOCK, kvh, r, d)
    pad = ((0, 0), (BLOCK, BLOCK), (0, 0), (0, 0))
    kp = jnp.pad(k, pad).reshape(b, nb + 2, BLOCK, kvh, d)
    vp = jnp.pad(v, pad).reshape(b, nb + 2, BLOCK, kvh, d)
    kw = jnp.concatenate([kp[:, :-2], kp[:, 1:-1], kp[:, 2:]], axis=2)
    vw = jnp.concatenate([vp[:, :-2], vp[:, 1:-1], vp[:, 2:]], axis=2)
    scale = HEAD_DIM ** -0.5
    s = jnp.einsum('bnqkrd,bnskd->bnkrqs', qb, kw).astype(jnp.float32) * scale
    blk = jnp.arange(nb)[:, None] * BLOCK
    qpos = blk + jnp.arange(BLOCK)[None, :]
    kpos = blk - BLOCK + jnp.arange(3 * BLOCK)[None, :]
    valid = (jnp.abs(qpos[:, :, None] - kpos[:, None, :]) <= WINDOW) \
        & (kpos >= 0)[:, None, :] & (kpos < l)[:, None, :]
    s = jnp.where(valid[None, :, None, None], s, -jnp.inf)
    sink_l = sink.astype(jnp.float32).reshape(kvh, r)[None, None, :, :, None, None]
    m = jnp.maximum(jnp.max(s, axis=-1, keepdims=True), sink_l)
    e = jnp.exp(s - m)
    probs = e / (jnp.sum(e, axis=-1, keepdims=True) + jnp.exp(sink_l - m))
    o = jnp.einsum('bnkrqs,bnskd->bnqkrd', probs.astype(v.dtype), vw)
    return o.reshape(b, l, h, d)


def setup_inputs(seed: int = 0) -> dict:
    key = jax.random.key(seed)
    ks = jax.random.split(key, 20)
    f32 = jnp.float32
    x = jax.random.normal(ks[0], (BATCH, SEQ, D_MODEL), f32)
    p = jax.random.normal(ks[1], (DEPTH, BATCH, SEQ, PLE_DIM), f32)
    norm_w = 1.0 + 0.02 * jax.random.normal(ks[2], (DEPTH, D_MODEL), f32)
    w_in = jax.random.normal(ks[3], (DEPTH, D_MODEL, IN_WIDTH), f32) * D_MODEL ** -0.5
    conv_w = jax.random.normal(ks[4], (DEPTH, D_CONV, XBC_WIDTH), f32) * D_CONV ** -0.5
    conv_b = 0.02 * jax.random.normal(ks[5], (DEPTH, XBC_WIDTH), f32)
    dt_f = jnp.exp(jax.random.uniform(ks[6], (DEPTH, SSD_HEADS), f32, np.log(1e-3), np.log(1e-1)))
    dt_b = jnp.exp(jax.random.uniform(ks[7], (DEPTH, SSD_HEADS), f32, np.log(1e-3), np.log(1e-1)))
    dt_bias_f = dt_f + jnp.log(-jnp.expm1(-dt_f))
    dt_bias_b = dt_b + jnp.log(-jnp.expm1(-dt_b))
    a_log_f = jnp.log(jax.random.uniform(ks[8], (DEPTH, SSD_HEADS), f32, 1.0, 16.0))
    a_log_b = jnp.log(jax.random.uniform(ks[9], (DEPTH, SSD_HEADS), f32, 1.0, 16.0))
    d_skip = 1.0 + 0.1 * jax.random.normal(ks[10], (DEPTH, SSD_HEADS), f32)
    ssd_norm_w = 1.0 + 0.02 * jax.random.normal(ks[11], (DEPTH, SSD_WIDTH), f32)
    attn_sink = 0.5 * jax.random.normal(ks[12], (DEPTH, N_HEADS), f32)
    attn_norm_w = 1.0 + 0.02 * jax.random.normal(ks[13], (DEPTH, ATTN_WIDTH), f32)
    w_out = jax.random.normal(ks[14], (DEPTH, MIX_WIDTH, D_MODEL), f32) * MIX_WIDTH ** -0.5
    ple_proj = jax.random.normal(ks[15], (DEPTH, PLE_DIM, D_MODEL), f32) * PLE_DIM ** -0.5
    ple_gate_w = jax.random.normal(ks[16], (DEPTH, D_MODEL, D_MODEL), f32) * D_MODEL ** -0.5
    ple_gate_b = 0.02 * jax.random.normal(ks[17], (DEPTH, D_MODEL), f32)
    final_norm_w = 1.0 + 0.02 * jax.random.normal(ks[18], (D_MODEL,), f32)
    return {"x": x, "p": p, "norm_w": norm_w, "w_in": w_in, "conv_w": conv_w, "conv_b": conv_b,
            "dt_bias_f": dt_bias_f, "dt_bias_b": dt_bias_b, "a_log_f": a_log_f, "a_log_b": a_log_b,
            "d_skip": d_skip, "ssd_norm_w": ssd_norm_w, "attn_sink": attn_sink,
            "attn_norm_w": attn_norm_w, "w_out": w_out, "ple_proj": ple_proj,
            "ple_gate_w": ple_gate_w, "ple_gate_b": ple_gate_b, "final_norm_w": final_norm_w}


def reference(x, p, norm_w, w_in, conv_w, conv_b, dt_bias_f, dt_bias_b, a_log_f, a_log_b,
              d_skip, ssd_norm_w, attn_sink, attn_norm_w, w_out, ple_proj, ple_gate_w,
              ple_gate_b, final_norm_w):
    b, l, _ = x.shape
    f32 = jnp.float32
    inv_freq = ROPE_THETA ** (-jnp.arange(0, ROT_DIM, 2, dtype=f32) / ROT_DIM)
    ang = jnp.arange(l, dtype=f32)[:, None] * inv_freq[None, :]
    cos, sin = jnp.cos(ang), jnp.sin(ang)
    split_idx = [int(v) for v in np.cumsum(IN_SPLIT_SIZES)[:-1]]

    for i in range(DEPTH):
        h = _rmsnorm(x, norm_w[i])
        proj = h @ w_in[i]
        z, xbc, dt_raw, q, k, v, g = jnp.split(proj, split_idx, axis=-1)

        xbc = lax.conv_general_dilated(
            xbc, conv_w[i][:, None, :].astype(xbc.dtype), window_strides=(1,),
            padding=[((D_CONV - 1) // 2, (D_CONV - 1) // 2)],
            dimension_numbers=('NWC', 'WIO', 'NWC'), feature_group_count=XBC_WIDTH)
        xbc = jax.nn.silu(xbc + conv_b[i])
        xs, Bm, Cm = jnp.split(xbc, [SSD_WIDTH, SSD_WIDTH + BC_WIDTH], axis=-1)
        xs = xs.reshape(b, l, SSD_HEADS, SSD_HEAD_DIM).astype(f32)
        Bm = Bm.reshape(b, l, SSD_GROUPS, D_STATE).astype(f32)
        Cm = Cm.reshape(b, l, SSD_GROUPS, D_STATE).astype(f32)
        dt_raw = dt_raw.astype(f32)
        dt_fw = jax.nn.softplus(dt_raw[..., :SSD_HEADS] + dt_bias_f[i].astype(f32))
        dt_bw = jax.nn.softplus(dt_raw[..., SSD_HEADS:] + dt_bias_b[i].astype(f32))
        A_fw = -jnp.exp(a_log_f[i].astype(f32))
        A_bw = -jnp.exp(a_log_b[i].astype(f32))
        y_fw = _ssd_chunked(xs, dt_fw, A_fw, Bm, Cm)
        y_bw = jnp.flip(_ssd_chunked(jnp.flip(xs, 1), jnp.flip(dt_bw, 1), A_bw,
                                     jnp.flip(Bm, 1), jnp.flip(Cm, 1)), 1)
        y = y_fw + y_bw + d_skip[i].astype(f32)[:, None] * xs
        y = y.reshape(b, l, SSD_WIDTH)
        y_ssd = _rmsnorm(y * jax.nn.silu(z.astype(f32)), ssd_norm_w[i]).astype(x.dtype)

        q = _rope_partial(q.reshape(b, l, N_HEADS, HEAD_DIM), cos, sin)
        k = _rope_partial(k.reshape(b, l, N_KV_HEADS, HEAD_DIM), cos, sin)
        v = v.reshape(b, l, N_KV_HEADS, HEAD_DIM)
        o = _window_attention(q, k, v, attn_sink[i]).reshape(b, l, ATTN_WIDTH)
        y_attn = _rmsnorm(o * jax.nn.silu(g), attn_norm_w[i])

        x = x + jnp.concatenate([y_ssd, y_attn], axis=-1) @ w_out[i]

        gate = jax.nn.sigmoid((x @ ple_gate_w[i] + ple_gate_b[i]).astype(f32))
        x = x + (gate * (p[i] @ ple_proj[i]).astype(f32)).astype(x.dtype)

    return _rmsnorm(x, final_norm_w)
```

```cpp
#include <hip/hip_runtime.h>
#include <stdint.h>

typedef unsigned short bf16_t;
typedef short bf16x8 __attribute__((ext_vector_type(8)));
typedef float f32x4 __attribute__((ext_vector_type(4)));
typedef unsigned u32x4 __attribute__((ext_vector_type(4)));

constexpr int BATCH = 2, SEQ = 8192, M = BATCH * SEQ, DM = 1024;
constexpr int NIN = 5152, NMAIN = 5120;
constexpr int XBCW = 1536, NH = 16, HD = 64, NKV = 4, PLE = 256;
constexpr float EPS = 1e-6f;
constexpr float C2 = 0.125f * 1.4426950408889634f;
constexpr float LOG2E = 1.4426950408889634f;

constexpr size_t MiB = 1u << 20;
constexpr size_t WS_CTL = 0;
constexpr size_t WS_ROPE = 1 * MiB;
constexpr size_t WS_RS = 1 * MiB + 512 * 1024;
constexpr size_t WS_WIN = 2 * MiB;
constexpr size_t WS_WOUT = 13 * MiB;
constexpr size_t WS_WG = 17 * MiB;
constexpr size_t WS_WP = 19 * MiB;
constexpr size_t WS_XB = 20 * MiB;
constexpr size_t WS_PB = 52 * MiB;
constexpr size_t WS_Z = 60 * MiB;
constexpr size_t WS_XBC = 92 * MiB;
constexpr size_t WS_YG = 140 * MiB;
constexpr size_t WS_K = 204 * MiB;
constexpr size_t WS_V = 212 * MiB;
constexpr size_t WS_G = 220 * MiB;
constexpr size_t WS_DT = 252 * MiB;
constexpr size_t WS_SSQ = 254 * MiB;

__device__ __forceinline__ unsigned f2bf(float f) { unsigned u = __builtin_bit_cast(unsigned, f); return (u + 0x7fffu + ((u >> 16) & 1u)) >> 16; }
__device__ __forceinline__ float bf2f(unsigned short h) { return __builtin_bit_cast(float, ((unsigned)h) << 16); }
__device__ __forceinline__ float silu_f(float v) { return v / (1.f + __expf(-v)); }
__device__ __forceinline__ float softplus_f(float v) { return fmaxf(v, 0.f) + log1pf(expf(-fabsf(v))); }

__host__ __device__ __forceinline__ int rope_perm(int s) { return s < 16 ? ((s >> 1) + 8 * (s & 1)) : s; }
__host__ __device__ __forceinline__ int win_src(int n) {
    if (n < 2560) return n;
    if (n < 3584) { int j = n - 2560; return 2592 + (j & ~63) + rope_perm(j & 63); }
    if (n < 3840) { int j = n - 3584; return 3616 + (j & ~63) + rope_perm(j & 63); }
    if (n < 4096) return 3872 + (n - 3840);
    if (n < 5120) return 4128 + (n - 4096);
    return 2560 + (n - 5120);
}

__global__ void k_transpose_w(const float* __restrict__ W, int K, int N, bf16_t* __restrict__ WT, const float* __restrict__ rowscale0, const float* __restrict__ rowscale1, int mode) {
    size_t idx = (size_t)blockIdx.x * 256 + threadIdx.x;
    if (idx >= (size_t)K * N) return;
    int n = (int)(idx / K), k = (int)(idx % K);
    int src = mode == 1 ? win_src(n) : n;
    float s = 1.f;
    if (rowscale0) s = (rowscale1 && k >= 1024) ? rowscale1[k - 1024] : rowscale0[k];
    WT[idx] = (bf16_t)f2bf(W[(size_t)k * N + src] * s);
}
__global__ void k_convert_x(const float* __restrict__ x, bf16_t* __restrict__ xb, float* __restrict__ rs) {
    int row = blockIdx.x * 4 + (threadIdx.x >> 6), lane = threadIdx.x & 63;
    const f32x4* xr = (const f32x4*)(x + (size_t)row * DM) + lane;
    float s = 0.f;
    _Pragma("unroll") for (int j = 0; j < 4; ++j) { f32x4 v = xr[64 * j]; s += v.x * v.x + v.y * v.y + v.z * v.z + v.w * v.w;
        unsigned long long o = (unsigned long long)(f2bf(v.x) | (f2bf(v.y) << 16)) | ((unsigned long long)(f2bf(v.z) | (f2bf(v.w) << 16)) << 32);
        ((unsigned long long*)(xb + (size_t)row * DM))[lane + 64 * j] = o; }
    for (int o = 1; o < 64; o <<= 1) s += __shfl_xor(s, o);
    if (lane == 0) rs[row] = 1.0f / sqrtf(s * (1.f / DM) + EPS);
}
__global__ void k_convert_p(const float* __restrict__ p, bf16_t* __restrict__ pb, size_t n) {
    size_t i = (size_t)blockIdx.x * 256 + threadIdx.x; if (i < n) pb[i] = (bf16_t)f2bf(p[i]);
}
__device__ __forceinline__ void sincos_d(double a, double& s, double& c) {
    const double k = rint(a * 0.63661977236758134308);
    double r = fma(-k, 1.57079632679489655800e+00, a); r = fma(-k, 6.12323399573676603587e-17, r);
    const double r2 = r * r;
    double sp = -7.6471637318198164759e-13; sp = fma(sp, r2, 1.6059043836821614599e-10); sp = fma(sp, r2, -2.5052108385441718775e-08); sp = fma(sp, r2, 2.7557319223985890653e-06);
    sp = fma(sp, r2, -1.9841269841269841270e-04); sp = fma(sp, r2, 8.3333333333333333333e-03); sp = fma(sp, r2, -1.6666666666666666667e-01); sp = fma(sp * r2, r, r);
    double cp = 4.7794773323873852974e-14; cp = fma(cp, r2, -1.1470745597729724714e-11); cp = fma(cp, r2, 2.0876756987868098979e-09); cp = fma(cp, r2, -2.7557319223985890653e-07);
    cp = fma(cp, r2, 2.4801587301587301587e-05); cp = fma(cp, r2, -1.3888888888888888889e-03); cp = fma(cp, r2, 4.1666666666666666667e-02); cp = fma(cp, r2, -0.5); cp = fma(cp, r2, 1.0);
    const int q = ((int)k) & 3;
    s = (q == 0) ? sp : (q == 1) ? cp : (q == 2) ? -sp : -cp;
    c = (q == 0) ? cp : (q == 1) ? -sp : (q == 2) ? -cp : sp;
}
__global__ void k_rope_table(float* __restrict__ tab) {
    int idx = blockIdx.x * 256 + threadIdx.x; if (idx >= SEQ * 8) return;
    int t = idx >> 3, i = idx & 7;
    const double invt[8] = {1.0, 0.19392274474868576, 0.03760603093086393, 0.007292664737217109, 0.001414213562373095, 0.0002742481756762073, 5.318295896944988e-05, 1.031338537721246e-05};
    const double inv = i == 0 ? invt[0] : i == 1 ? invt[1] : i == 2 ? invt[2] : i == 3 ? invt[3] : i == 4 ? invt[4] : i == 5 ? invt[5] : i == 6 ? invt[6] : invt[7];
    double s, c; sincos_d((double)t * inv, s, c);
    tab[idx] = (float)c; tab[SEQ * 8 + idx] = (float)s;
}

template <class Epi>
__global__ void __launch_bounds__(256) k_gemm(const bf16_t* __restrict__ A, int lda, const bf16_t* __restrict__ Bt, int ldb, int N, int K, Epi epi) {
    __shared__ __attribute__((aligned(16))) bf16_t sA[64][40];
    __shared__ __attribute__((aligned(16))) bf16_t sB[64][40];
    const int tid = threadIdx.x, lane = tid & 63, wid = tid >> 6, wr = wid >> 1, wc = wid & 1, fr = lane & 15, fq = lane >> 4;
    const int bm = blockIdx.y * 64, bn = blockIdx.x * 64;
    const int lr = tid >> 2, lc = (tid & 3) * 8;
    f32x4 acc[2][2];
    for (int i = 0; i < 2; ++i) for (int j = 0; j < 2; ++j) acc[i][j] = (f32x4){0.f, 0.f, 0.f, 0.f};
    for (int k0 = 0; k0 < K; k0 += 32) {
        u32x4 va = *(const u32x4*)(A + (size_t)(bm + lr) * lda + k0 + lc);
        u32x4 vb = (u32x4){0u, 0u, 0u, 0u};
        if (bn + lr < N) vb = *(const u32x4*)(Bt + (size_t)(bn + lr) * ldb + k0 + lc);
        __syncthreads();
        *(u32x4*)&sA[lr][lc] = va; *(u32x4*)&sB[lr][lc] = vb;
        __syncthreads();
        bf16x8 a[2], b[2];
        for (int i = 0; i < 2; ++i) { a[i] = *(const bf16x8*)&sA[wr * 32 + i * 16 + fr][fq * 8]; b[i] = *(const bf16x8*)&sB[wc * 32 + i * 16 + fr][fq * 8]; }
        for (int i = 0; i < 2; ++i) for (int j = 0; j < 2; ++j) acc[i][j] = __builtin_amdgcn_mfma_f32_16x16x32_bf16(a[i], b[j], acc[i][j], 0, 0, 0);
    }
    for (int i = 0; i < 2; ++i) for (int j = 0; j < 2; ++j) for (int r = 0; r < 4; ++r) {
        const int row = bm + wr * 32 + i * 16 + fq * 4 + r, col = bn + wc * 32 + j * 16 + fr;
        if (col < N) epi(row, col, acc[i][j][r]);
    }
}
struct EpiInProj {
    const float* rs; bf16_t *Z, *XBC, *YG, *Kb, *Vb, *G; float* DT;
    __device__ void operator()(int row, int col, float v) const {
        v *= rs[row];
        if (col < 1024) Z[(size_t)row * 1024 + col] = (bf16_t)f2bf(v);
        else if (col < 2560) XBC[(size_t)row * XBCW + (col - 1024)] = (bf16_t)f2bf(v);
        else if (col < 3584) YG[(size_t)row * 2048 + 1024 + (col - 2560)] = (bf16_t)f2bf(v);
        else if (col < 3840) Kb[(size_t)row * 256 + (col - 3584)] = (bf16_t)f2bf(v);
        else if (col < 4096) Vb[(size_t)row * 256 + (col - 3840)] = (bf16_t)f2bf(v);
        else if (col < 5120) G[(size_t)row * 1024 + (col - 4096)] = (bf16_t)f2bf(v);
        else DT[(size_t)row * 32 + (col - 5120)] = v;
    }
};
struct EpiF32 { float* O; int ldc; __device__ void operator()(int row, int col, float v) const { O[(size_t)row * ldc + col] = v; } };
struct EpiBf16 { bf16_t* O; int ldc; __device__ void operator()(int row, int col, float v) const { O[(size_t)row * ldc + col] = (bf16_t)f2bf(v); } };
struct EpiOutProj {
    const float* x; float* out; bf16_t* x1b;
    __device__ void operator()(int row, int col, float v) const { const size_t o = (size_t)row * DM + col; const float r = x[o] + v; out[o] = r; x1b[o] = (bf16_t)f2bf(r); }
};
struct EpiGate {
    float* out; const bf16_t* pp; const float* gb;
    __device__ void operator()(int row, int col, float v) const { const size_t o = (size_t)row * DM + col; const float g = 1.f / (1.f + __expf(-(v + gb[col]))); out[o] = out[o] + g * bf2f(pp[o]); }
};

__global__ void k_rope(bf16_t* __restrict__ YG, bf16_t* __restrict__ Kb, const float* __restrict__ tab) {
    size_t idx = (size_t)blockIdx.x * 256 + threadIdx.x; if (idx >= (size_t)M * 20 * 8) return;
    const int i = (int)(idx & 7), hh = (int)((idx >> 3) % 20), row = (int)(idx / 160), t = row & (SEQ - 1);
    const float c = tab[t * 8 + i], s = tab[SEQ * 8 + t * 8 + i];
    bf16_t* p = hh < 16 ? YG + (size_t)row * 2048 + 1024 + hh * 64 + 2 * i : Kb + (size_t)row * 256 + (hh - 16) * 64 + 2 * i;
    const float a = bf2f(p[0]), b = bf2f(p[1]);
    const float sc = hh < 16 ? C2 : 1.f;
    p[0] = (bf16_t)f2bf((a * c - b * s) * sc); p[1] = (bf16_t)f2bf((b * c + a * s) * sc);
}
__global__ void k_scale_q_rest(bf16_t* __restrict__ YG) {
    size_t idx = (size_t)blockIdx.x * 256 + threadIdx.x; if (idx >= (size_t)M * 16 * 48) return;
    const int d = (int)(idx % 48) + 16, h = (int)((idx / 48) & 15), row = (int)(idx / (48 * 16));
    bf16_t* p = YG + (size_t)row * 2048 + 1024 + h * 64 + d; *p = (bf16_t)f2bf(bf2f(*p) * C2);
}

__global__ void k_conv(const bf16_t* __restrict__ XBC, const float* __restrict__ cw, const float* __restrict__ cb, bf16_t* __restrict__ XC) {
    size_t idx = (size_t)blockIdx.x * 256 + threadIdx.x; if (idx >= (size_t)M * XBCW) return;
    const int c = (int)(idx % XBCW), row = (int)(idx / XBCW), t = row & (SEQ - 1);
    float v = cb[c] + cw[XBCW + c] * bf2f(XBC[idx]);
    if (t > 0) v += cw[c] * bf2f(XBC[idx - XBCW]);
    if (t < SEQ - 1) v += cw[2 * XBCW + c] * bf2f(XBC[idx + XBCW]);
    XC[idx] = (bf16_t)f2bf(silu_f(v));
}
__global__ void k_dt(float* __restrict__ DT, const float* __restrict__ bf_, const float* __restrict__ bb_) {
    size_t idx = (size_t)blockIdx.x * 256 + threadIdx.x; if (idx >= (size_t)M * 32) return;
    const int j = (int)(idx & 31);
    DT[idx] = softplus_f(DT[idx] + (j < 16 ? bf_[j] : bb_[j - 16]));
}
__global__ void __launch_bounds__(256) k_ssd_naive(const bf16_t* __restrict__ XC, const float* __restrict__ DT, const float* __restrict__ alf, const float* __restrict__ alb,
                                                   const float* __restrict__ dskip, const bf16_t* __restrict__ Z, bf16_t* __restrict__ YG) {
    extern __shared__ float yf[];
    const int wid = threadIdx.x >> 6, lane = threadIdx.x & 63;
    const int pb = blockIdx.x & 15, h = (blockIdx.x >> 4) & 15, b = blockIdx.x >> 8, p = pb * 4 + wid, g = h >> 3;
    const float Af = -expf(alf[h]), Ab = -expf(alb[h]), Dk = dskip[h];
    float* myf = yf + wid * SEQ;
    float h0 = 0.f, h1 = 0.f;
    for (int t = 0; t < SEQ; ++t) {
        const size_t row = (size_t)b * SEQ + t; const bf16_t* xr = XC + row * XBCW;
        const float dt = DT[row * 32 + h], xv = bf2f(xr[h * 64 + p]), dA = expf(dt * Af), dx = dt * xv;
        h0 = h0 * dA + dx * bf2f(xr[1024 + g * 128 + lane]); h1 = h1 * dA + dx * bf2f(xr[1024 + g * 128 + 64 + lane]);
        float y = h0 * bf2f(xr[1280 + g * 128 + lane]) + h1 * bf2f(xr[1280 + g * 128 + 64 + lane]);
        for (int o = 1; o < 64; o <<= 1) y += __shfl_xor(y, o);
        if (lane == 0) myf[t] = y;
    }
    h0 = 0.f; h1 = 0.f;
    for (int t = SEQ - 1; t >= 0; --t) {
        const size_t row = (size_t)b * SEQ + t; const bf16_t* xr = XC + row * XBCW;
        const float dt = DT[row * 32 + 16 + h], xv = bf2f(xr[h * 64 + p]), dA = expf(dt * Ab), dx = dt * xv;
        h0 = h0 * dA + dx * bf2f(xr[1024 + g * 128 + lane]); h1 = h1 * dA + dx * bf2f(xr[1024 + g * 128 + 64 + lane]);
        float y = h0 * bf2f(xr[1280 + g * 128 + lane]) + h1 * bf2f(xr[1280 + g * 128 + 64 + lane]);
        for (int o = 1; o < 64; o <<= 1) y += __shfl_xor(y, o);
        if (lane == 0) { const float yt = myf[t] + y + Dk * xv; const float z = bf2f(Z[row * 1024 + h * 64 + p]); YG[row * 2048 + h * 64 + p] = (bf16_t)f2bf(yt * silu_f(z)); }
    }
}

__global__ void __launch_bounds__(128) k_attn_naive(bf16_t* __restrict__ YG, const bf16_t* __restrict__ Kb, const bf16_t* __restrict__ Vb, const bf16_t* __restrict__ G, const float* __restrict__ sink) {
    const int h = blockIdx.y, kvh = h >> 2, blk = blockIdx.x, b = blk >> 6, nb = blk & 63, tq = nb * 128 + threadIdx.x;
    const size_t row = (size_t)b * SEQ + tq;
    bf16_t* qp = YG + row * 2048 + 1024 + h * 64;
    float q[64], o[64];
    _Pragma("unroll") for (int d = 0; d < 64; ++d) { q[d] = bf2f(qp[d]); o[d] = 0.f; }
    float m = sink[h] * LOG2E, l = 1.f;
    for (int j = 0; j < 384; ++j) {
        const int tk = nb * 128 - 128 + j;
        if (tk < 0 || tk >= SEQ) continue;
        const bf16_t* kr = Kb + ((size_t)b * SEQ + tk) * 256 + kvh * 64; const bf16_t* vr = Vb + ((size_t)b * SEQ + tk) * 256 + kvh * 64;
        float s = 0.f;
        _Pragma("unroll") for (int d = 0; d < 64; ++d) s += q[d] * bf2f(kr[d]);
        const int dd = tq - tk;
        if (dd > 128 || dd < -128) continue;
        const float mn = fmaxf(m, s), al = exp2f(m - mn), pe = exp2f(s - mn);
        l = l * al + pe; m = mn;
        _Pragma("unroll") for (int d = 0; d < 64; ++d) o[d] = o[d] * al + pe * bf2f(vr[d]);
    }
    const float il = 1.f / l; const bf16_t* gp = G + row * 1024 + h * 64;
    _Pragma("unroll") for (int d = 0; d < 64; ++d) qp[d] = (bf16_t)f2bf(o[d] * il * silu_f(bf2f(gp[d])));
}

__global__ void k_yg_norm(bf16_t* __restrict__ YG) {
    const int row = blockIdx.x * 4 + (threadIdx.x >> 6), lane = threadIdx.x & 63;
    bf16_t* r = YG + (size_t)row * 2048;
    for (int half = 0; half < 2; ++half) {
        float v[16]; float s = 0.f;
        _Pragma("unroll") for (int j = 0; j < 16; ++j) { v[j] = bf2f(r[half * 1024 + j * 64 + lane]); s += v[j] * v[j]; }
        for (int o = 1; o < 64; o <<= 1) s += __shfl_xor(s, o);
        const float sc = 1.0f / sqrtf(s * (1.f / 1024.f) + EPS);
        _Pragma("unroll") for (int j = 0; j < 16; ++j) r[half * 1024 + j * 64 + lane] = (bf16_t)f2bf(v[j] * sc);
    }
}
__global__ void k_final_norm(float* __restrict__ out, const float* __restrict__ w) {
    const int row = blockIdx.x * 4 + (threadIdx.x >> 6), lane = threadIdx.x & 63;
    f32x4* r = (f32x4*)(out + (size_t)row * DM) + lane; const f32x4* wr = (const f32x4*)w + lane;
    f32x4 v[4]; float s = 0.f;
    _Pragma("unroll") for (int j = 0; j < 4; ++j) { v[j] = r[64 * j]; s += v[j].x * v[j].x + v[j].y * v[j].y + v[j].z * v[j].z + v[j].w * v[j].w; }
    for (int o = 1; o < 64; o <<= 1) s += __shfl_xor(s, o);
    const float sc = 1.0f / sqrtf(s * (1.f / DM) + EPS);
    _Pragma("unroll") for (int j = 0; j < 4; ++j) { const f32x4 ww = wr[64 * j]; r[64 * j] = (f32x4){v[j].x * sc * ww.x, v[j].y * sc * ww.y, v[j].z * sc * ww.z, v[j].w * sc * ww.w}; }
}

extern "C" void kernel_launch(void* const* d_in, const int* in_sizes, int n_in, void* d_out, int out_size, void* d_ws, size_t ws_size, hipStream_t stream) {
    const float* x = (const float*)d_in[0]; const float* p = (const float*)d_in[1]; const float* norm_w = (const float*)d_in[2]; const float* w_in = (const float*)d_in[3];
    const float* conv_w = (const float*)d_in[4]; const float* conv_b = (const float*)d_in[5]; const float* dtb_f = (const float*)d_in[6]; const float* dtb_b = (const float*)d_in[7];
    const float* alf = (const float*)d_in[8]; const float* alb = (const float*)d_in[9]; const float* dskip = (const float*)d_in[10]; const float* ssd_nw = (const float*)d_in[11];
    const float* sink = (const float*)d_in[12]; const float* attn_nw = (const float*)d_in[13]; const float* w_out = (const float*)d_in[14]; const float* ple_proj = (const float*)d_in[15];
    const float* ple_gw = (const float*)d_in[16]; const float* ple_gb = (const float*)d_in[17]; const float* fin_w = (const float*)d_in[18];
    unsigned char* ws = (unsigned char*)d_ws; float* out = (float*)d_out;
    float* ROPE = (float*)(ws + WS_ROPE); float* RS = (float*)(ws + WS_RS);
    bf16_t* WIN = (bf16_t*)(ws + WS_WIN); bf16_t* WOUT = (bf16_t*)(ws + WS_WOUT); bf16_t* WG = (bf16_t*)(ws + WS_WG); bf16_t* WP = (bf16_t*)(ws + WS_WP);
    bf16_t* XB = (bf16_t*)(ws + WS_XB); bf16_t* PB = (bf16_t*)(ws + WS_PB); bf16_t* Z = (bf16_t*)(ws + WS_Z); bf16_t* XBC = (bf16_t*)(ws + WS_XBC);
    bf16_t* YG = (bf16_t*)(ws + WS_YG); bf16_t* Kb = (bf16_t*)(ws + WS_K); bf16_t* Vb = (bf16_t*)(ws + WS_V); bf16_t* G = (bf16_t*)(ws + WS_G); float* DT = (float*)(ws + WS_DT);
    bf16_t* XC = (bf16_t*)d_out;
    bf16_t* PP = XBC;
    bf16_t* X1B = XB;

    auto nb = [](size_t n) { return (unsigned)((n + 255) / 256); };
    k_transpose_w<<<nb((size_t)DM * NIN), 256, 0, stream>>>(w_in, DM, NIN, WIN, norm_w, nullptr, 1);
    k_transpose_w<<<nb((size_t)2048 * DM), 256, 0, stream>>>(w_out, 2048, DM, WOUT, ssd_nw, attn_nw, 0);
    k_transpose_w<<<nb((size_t)DM * DM), 256, 0, stream>>>(ple_gw, DM, DM, WG, nullptr, nullptr, 0);
    k_transpose_w<<<nb((size_t)PLE * DM), 256, 0, stream>>>(ple_proj, PLE, DM, WP, nullptr, nullptr, 0);
    k_convert_x<<<M / 4, 256, 0, stream>>>(x, XB, RS);
    k_convert_p<<<nb((size_t)M * PLE), 256, 0, stream>>>(p, PB, (size_t)M * PLE);
    k_rope_table<<<nb(SEQ * 8), 256, 0, stream>>>(ROPE);
    { EpiInProj e{RS, Z, XBC, YG, Kb, Vb, G, DT}; k_gemm<EpiInProj><<<dim3((NIN + 63) / 64, M / 64), 256, 0, stream>>>(XB, DM, WIN, DM, NIN, DM, e); }
    k_rope<<<nb((size_t)M * 160), 256, 0, stream>>>(YG, Kb, ROPE);
    k_scale_q_rest<<<nb((size_t)M * 16 * 48), 256, 0, stream>>>(YG);
    k_conv<<<nb((size_t)M * XBCW), 256, 0, stream>>>(XBC, conv_w, conv_b, XC);
    k_dt<<<nb((size_t)M * 32), 256, 0, stream>>>(DT, dtb_f, dtb_b);
    static bool attr_set = false;
    if (!attr_set) { (void)hipFuncSetAttribute((const void*)k_ssd_naive, hipFuncAttributeMaxDynamicSharedMemorySize, 4 * SEQ * 4); attr_set = true; }
    k_ssd_naive<<<BATCH * 16 * 16, 256, 4 * SEQ * 4, stream>>>(XC, DT, alf, alb, dskip, Z, YG);
    k_attn_naive<<<dim3(BATCH * 64, NH), 128, 0, stream>>>(YG, Kb, Vb, G, sink);
    k_yg_norm<<<M / 4, 256, 0, stream>>>(YG);
    { EpiBf16 e{PP, DM}; k_gemm<EpiBf16><<<dim3(DM / 64, M / 64), 256, 0, stream>>>(PB, PLE, WP, PLE, DM, PLE, e); }
    { EpiOutProj e{x, out, X1B}; k_gemm<EpiOutProj><<<dim3(DM / 64, M / 64), 256, 0, stream>>>(YG, 2048, WOUT, 2048, DM, 2048, e); }
    { EpiGate e{out, PP, ple_gb}; k_gemm<EpiGate><<<dim3(DM / 64, M / 64), 256, 0, stream>>>(X1B, DM, WG, DM, DM, DM, e); }
    k_final_norm<<<M / 4, 256, 0, stream>>>(out, fin_w);
}
```
